# Optimizing an MI355X kernel written in HIP

```python
import math
import jax, jax.numpy as jnp
from jax import lax
import numpy as np

D_MODEL = 1024
BATCH = 8
SEQ = 2048
DEPTH = 1

LRU_WIDTH = D_MODEL
LRU_HEADS = 16
LRU_HEAD_DIM = LRU_WIDTH // LRU_HEADS
CONV_WIDTH = 4
LRU_C = 8.0
S5_WIDTH = D_MODEL // 2
S5_GROUP = 16
S5_GROUPS = S5_WIDTH // S5_GROUP
S5_STATE = 64
D_FF = 2816
EPS = 1e-6
N_MOD = 9
IN_COLS = 2 * LRU_WIDTH + S5_WIDTH + 2 * D_MODEL

kernel_name = 'hybrid_rglru_s5_macaron_adaln'


def rms_norm(x, g):
    xf = x.astype(jnp.float32)
    y = xf * lax.rsqrt(jnp.mean(xf * xf, axis=-1, keepdims=True) + EPS)
    return (y * g.astype(jnp.float32)).astype(x.dtype)


def modulate(n, shift, scale):
    return n * (1.0 + scale[:, None, :]) + shift[:, None, :]


def swiglu(u, w_up, w_down):
    a, b = jnp.split(u @ w_up, 2, axis=-1)
    return (jax.nn.silu(a) * b) @ w_down


def causal_depthwise_conv(x, w, b):
    s = x.shape[1]
    xp = jnp.pad(x, ((0, 0), (CONV_WIDTH - 1, 0), (0, 0)))
    y = b
    for k in range(CONV_WIDTH):
        y = y + xp[:, k:k + s, :] * w[k]
    return y


def rg_lru(x, w_r, b_r, w_i, b_i, lam):
    bsz, s, wd = x.shape
    xh = x.reshape(bsz, s, LRU_HEADS, LRU_HEAD_DIM)
    r = jax.nn.sigmoid(jnp.einsum('bshi,hij->bshj', xh, w_r).reshape(bsz, s, wd) + b_r)
    i = jax.nn.sigmoid(jnp.einsum('bshi,hij->bshj', xh, w_i).reshape(bsz, s, wd) + b_i)
    log_a = -LRU_C * r.astype(jnp.float32) * jax.nn.softplus(-lam.astype(jnp.float32))
    a = jnp.exp(log_a)
    mult = jnp.sqrt(-jnp.expm1(2.0 * log_a))
    u = mult * (i * x).astype(jnp.float32)

    def combine(left, right):
        a1, b1 = left
        a2, b2 = right
        return a1 * a2, a2 * b1 + b2

    _, h = lax.associative_scan(combine, (a, u), axis=1)
    return h.astype(x.dtype)


def s5_ssm(x, a_re, a_im, log_dt, b_re, b_im, c_re, c_im, d_skip):
    bsz, s, _ = x.shape
    xf = x.astype(jnp.float32)
    xg = xf.reshape(bsz, s, S5_GROUPS, S5_GROUP)
    a_re = a_re.astype(jnp.float32)
    a_im = a_im.astype(jnp.float32)
    dt = jnp.exp(log_dt.astype(jnp.float32))[:, None]
    mag = jnp.exp(a_re * dt)
    lr = mag * jnp.cos(a_im * dt)
    li = mag * jnp.sin(a_im * dt)
    den = a_re * a_re + a_im * a_im
    nr = lr - 1.0
    cr = (nr * a_re + li * a_im) / den
    ci = (li * a_re - nr * a_im) / den
    bx_re = jnp.einsum('bsgh,gph->bsgp', xg, b_re.astype(jnp.float32))
    bx_im = jnp.einsum('bsgh,gph->bsgp', xg, b_im.astype(jnp.float32))
    u_re = cr * bx_re - ci * bx_im
    u_im = cr * bx_im + ci * bx_re
    lam_re = jnp.broadcast_to(lr, (1, s, S5_GROUPS, S5_STATE))
    lam_im = jnp.broadcast_to(li, (1, s, S5_GROUPS, S5_STATE))

    def combine(left, right):
        ar1, ai1, br1, bi1 = left
        ar2, ai2, br2, bi2 = right
        return (ar2 * ar1 - ai2 * ai1,
                ar2 * ai1 + ai2 * ar1,
                ar2 * br1 - ai2 * bi1 + br2,
                ar2 * bi1 + ai2 * br1 + bi2)

    _, _, h_re, h_im = lax.associative_scan(combine, (lam_re, lam_im, u_re, u_im), axis=1)
    y = (jnp.einsum('bsgp,ghp->bsgh', h_re, c_re.astype(jnp.float32))
         - jnp.einsum('bsgp,ghp->bsgh', h_im, c_im.astype(jnp.float32)))
    y = y.reshape(bsz, s, S5_WIDTH) + d_skip.astype(jnp.float32) * xf
    return y.astype(x.dtype)


def setup_inputs(seed: int = 0) -> dict:
    key = jax.random.key(seed)
    ks = iter(jax.random.split(key, 40))
    L = DEPTH
    f32 = jnp.float32

    def nrm(shape, scale):
        return scale * jax.random.normal(next(ks), shape, f32)

    def gain(shape):
        return 1.0 + nrm(shape, 0.02)

    x = nrm((BATCH, SEQ, D_MODEL), 1.0)
    c = nrm((BATCH, D_MODEL), 1.0)
    mod_w = nrm((L, D_MODEL, N_MOD * D_MODEL), 0.3 * D_MODEL ** -0.5)
    mod_b = nrm((L, N_MOD * D_MODEL), 0.02)
    norm1_g = gain((L, D_MODEL))
    ffn1_w_up = nrm((L, D_MODEL, 2 * D_FF), D_MODEL ** -0.5)
    ffn1_w_down = nrm((L, D_FF, D_MODEL), D_FF ** -0.5)
    norm2_g = gain((L, D_MODEL))
    w_in = nrm((L, D_MODEL, IN_COLS), D_MODEL ** -0.5)
    b_in = nrm((L, IN_COLS), 0.02)
    conv_w = nrm((L, CONV_WIDTH, LRU_WIDTH), CONV_WIDTH ** -0.5)
    conv_b = nrm((L, LRU_WIDTH), 0.02)
    lru_w_r = nrm((L, LRU_HEADS, LRU_HEAD_DIM, LRU_HEAD_DIM), LRU_HEAD_DIM ** -0.5)
    lru_b_r = nrm((L, LRU_WIDTH), 0.02)
    lru_w_i = nrm((L, LRU_HEADS, LRU_HEAD_DIM, LRU_HEAD_DIM), LRU_HEAD_DIM ** -0.5)
    lru_b_i = nrm((L, LRU_WIDTH), 0.02)
    a0 = jax.random.uniform(next(ks), (L, LRU_WIDTH), f32, minval=0.9, maxval=0.999)
    base = a0 ** (1.0 / LRU_C)
    lru_lambda = jnp.log(base) - jnp.log1p(-base)
    proj_a = nrm((L, LRU_WIDTH, D_MODEL), LRU_WIDTH ** -0.5)
    s5_a_re = -0.5 + nrm((L, S5_GROUPS, S5_STATE), 0.01)
    s5_a_im = math.pi * jnp.arange(S5_STATE, dtype=f32)[None, None, :] + nrm((L, S5_GROUPS, S5_STATE), 0.01)
    s5_log_dt = jax.random.uniform(next(ks), (L, S5_GROUPS), f32, minval=math.log(1e-3), maxval=math.log(1e-1))
    s5_b_re = nrm((L, S5_GROUPS, S5_STATE, S5_GROUP), (2.0 * S5_GROUP) ** -0.5)
    s5_b_im = nrm((L, S5_GROUPS, S5_STATE, S5_GROUP), (2.0 * S5_GROUP) ** -0.5)
    s5_c_re = nrm((L, S5_GROUPS, S5_GROUP, S5_STATE), (2.0 * S5_STATE) ** -0.5)
    s5_c_im = nrm((L, S5_GROUPS, S5_GROUP, S5_STATE), (2.0 * S5_STATE) ** -0.5)
    s5_d = nrm((L, S5_WIDTH), 1.0)
    glu_w = nrm((L, S5_WIDTH, S5_WIDTH), S5_WIDTH ** -0.5)
    glu_b = nrm((L, S5_WIDTH), 0.02)
    proj_b = nrm((L, S5_WIDTH, D_MODEL), S5_WIDTH ** -0.5)
    w_out = nrm((L, D_MODEL, D_MODEL), D_MODEL ** -0.5)
    norm3_g = gain((L, D_MODEL))
    ffn2_w_up = nrm((L, D_MODEL, 2 * D_FF), D_MODEL ** -0.5)
    ffn2_w_down = nrm((L, D_FF, D_MODEL), D_FF ** -0.5)
    final_g = gain((D_MODEL,))
    return {'x': x, 'c': c, 'mod_w': mod_w, 'mod_b': mod_b,
            'norm1_g': norm1_g, 'ffn1_w_up': ffn1_w_up, 'ffn1_w_down': ffn1_w_down,
            'norm2_g': norm2_g, 'w_in': w_in, 'b_in': b_in,
            'conv_w': conv_w, 'conv_b': conv_b,
            'lru_w_r': lru_w_r, 'lru_b_r': lru_b_r, 'lru_w_i': lru_w_i, 'lru_b_i': lru_b_i,
            'lru_lambda': lru_lambda, 'proj_a': proj_a,
            's5_a_re': s5_a_re, 's5_a_im': s5_a_im, 's5_log_dt': s5_log_dt,
            's5_b_re': s5_b_re, 's5_b_im': s5_b_im, 's5_c_re': s5_c_re, 's5_c_im': s5_c_im,
            's5_d': s5_d, 'glu_w': glu_w, 'glu_b': glu_b, 'proj_b': proj_b,
            'w_out': w_out, 'norm3_g': norm3_g, 'ffn2_w_up': ffn2_w_up, 'ffn2_w_down': ffn2_w_down,
            'final_g': final_g}


def reference(x, c, mod_w, mod_b, norm1_g, ffn1_w_up, ffn1_w_down, norm2_g, w_in, b_in,
              conv_w, conv_b, lru_w_r, lru_b_r, lru_w_i, lru_b_i, lru_lambda, proj_a,
              s5_a_re, s5_a_im, s5_log_dt, s5_b_re, s5_b_im, s5_c_re, s5_c_im,
              s5_d, glu_w, glu_b, proj_b, w_out, norm3_g, ffn2_w_up, ffn2_w_down, final_g):
    c_act = jax.nn.silu(c)
    split_pts = [LRU_WIDTH, 2 * LRU_WIDTH, 2 * LRU_WIDTH + S5_WIDTH, 2 * LRU_WIDTH + S5_WIDTH + D_MODEL]
    for l in range(DEPTH):
        mod = c_act @ mod_w[l] + mod_b[l]
        sh1, sc1, g1, sh2, sc2, g2, sh3, sc3, g3 = jnp.split(mod, N_MOD, axis=-1)

        u = modulate(rms_norm(x, norm1_g[l]), sh1, sc1)
        x = x + 0.5 * g1[:, None, :] * swiglu(u, ffn1_w_up[l], ffn1_w_down[l])

        u = modulate(rms_norm(x, norm2_g[l]), sh2, sc2)
        z = u @ w_in[l] + b_in[l]
        xa, ga, xb, mg_a, mg_b = jnp.split(z, split_pts, axis=-1)
        xa = causal_depthwise_conv(xa, conv_w[l], conv_b[l])
        ya = rg_lru(xa, lru_w_r[l], lru_b_r[l], lru_w_i[l], lru_b_i[l], lru_lambda[l]) * jax.nn.gelu(ga)
        yb = jax.nn.gelu(s5_ssm(xb, s5_a_re[l], s5_a_im[l], s5_log_dt[l], s5_b_re[l], s5_b_im[l],
                                s5_c_re[l], s5_c_im[l], s5_d[l]))
        yb = yb * jax.nn.sigmoid(yb @ glu_w[l] + glu_b[l])
        m = jax.nn.sigmoid(mg_a) * (ya @ proj_a[l]) + jax.nn.sigmoid(mg_b) * (yb @ proj_b[l])
        x = x + g2[:, None, :] * (m @ w_out[l])

        u = modulate(rms_norm(x, norm3_g[l]), sh3, sc3)
        x = x + 0.5 * g3[:, None, :] * swiglu(u, ffn2_w_up[l], ffn2_w_down[l])
    return rms_norm(x, final_g)
```

```cpp
#include <hip/hip_runtime.h>
#include <hip/hip_cooperative_groups.h>
#include <cstdio>
#include <cstdint>
namespace cg = cooperative_groups;
#ifndef USE_CG
#define USE_CG 0
#endif
namespace pg8 {
#define PG8_LAS __attribute__((address_space(3)))
typedef unsigned short bf16_t;
typedef short bf16x8 __attribute__((ext_vector_type(8)));
typedef float f32x4 __attribute__((ext_vector_type(4)));
typedef unsigned u32x4 __attribute__((ext_vector_type(4)));
constexpr int BM = 256, BK = 64, HALF = 128, HTB = HALF * BK * 2  , STAGE_BYTES = 8 * HTB, NXCD = 8, WGM = 8;

__host__ __device__ __forceinline__ int lds_byte(int r, int c) { const int st = (r >> 4) * 2 + (c >> 5), rr = r & 15, cc = c & 31, ob = rr * 64 + cc * 2; return st * 1024 + (ob ^ (((ob >> 9) & 1) << 5)); }
__host__ __device__ __forceinline__ void stage_rc(int b, int& R, int& C) { const int st = b / 1024, sb = b % 1024, swz = sb ^ (((sb >> 9) & 1) << 5); R = (st >> 1) * 16 + swz / 64; C = (st & 1) * 32 + (swz % 64) / 2; }
__host__ __device__ __forceinline__ int perm32(int rho) { const int n = rho >> 4, i = rho & 15; return 8 * (i >> 2) + 4 * n + (i & 3); }

struct Unit { int pm, pn; };
struct Gemm { const bf16_t* A; const bf16_t* Bt; int M, N, K; };

struct StaticOrder {
    int nM, nN, nwg, G, c;
    __host__ __device__ void init(int M, int N, int G_, int c_) { nM = M / BM; nN = N / BM; nwg = nM * nN; G = G_; c = c_; }
    __host__ __device__ bool next(int i, Unit& u) const {
        const long L = (long)i * G + c; if (L >= nwg) return false;
        int wgid = (int)L; { const int q = nwg / NXCD, r = nwg % NXCD, xcd = wgid % NXCD, off = wgid / NXCD; wgid = (xcd < r ? xcd * (q + 1) : r * (q + 1) + (xcd - r) * q) + off; }
        const int nig = WGM * nN, gid = wgid / nig, fm = gid * WGM, gsz = (nM - fm) < WGM ? (nM - fm) : WGM;
        u.pm = fm + ((wgid % nig) % gsz); u.pn = (wgid % nig) / gsz; return true;
    }
    __device__ __forceinline__ void a_ready(const Unit&) const {}
    __device__ __forceinline__ void done(const Unit&) const {}
};
__device__ __forceinline__ unsigned cvt_pk_bf16(float lo, float hi) { unsigned r; asm volatile("v_cvt_pk_bf16_f32 %0, %1, %2" : "=v"(r) : "v"(lo), "v"(hi)); return r; }
template <class Epi, class Sched, bool ALIGN_EPI = false, bool SP2 = false>
__device__ __forceinline__ void gemm_phase(PG8_LAS unsigned char* lds, const Gemm g, const Sched& S, const Epi& E, const int tid_in) {
    const int tid = tid_in, wid = __builtin_amdgcn_readfirstlane(tid >> 6), lane = tid & 63, wr = wid >> 2, wc = wid & 3, fr = lane & 15, fq = lane >> 4;
    const int K = g.K, nt = K / BK;
    unsigned voffA[2], voffB[2];
#pragma unroll
    for (int i = 0; i < 2; ++i) { int R, C; stage_rc(tid * 16 + i * 8192, R, C); const int Rb = Epi::PERM ? ((R & ~31) + perm32(R & 31)) : R;
        voffA[i] = (unsigned)(R * K + C) * 2u; voffB[i] = (unsigned)(Rb * K + C) * 2u; }
    const size_t kstep = (size_t)(BK * 2);
    const size_t hstep = (size_t)HALF * K * 2;
    const size_t tstep = 2 * hstep;
    const unsigned ldsw = (unsigned)wid * 1024u;
    const int aoff = lds_byte(wr * 64 + fr, fq * 8), boff = lds_byte(wc * 32 + fr, fq * 8);
#define PG8_SA(b, h) (((b) * 2 + (h)) * HTB)
#define PG8_SB(b, h) ((4 + (b) * 2 + (h)) * HTB)
#define PG8_STAGE(bufoff, gbase, voff) do { _Pragma("unroll") for (int _i = 0; _i < 2; ++_i) \
        __builtin_amdgcn_global_load_lds((const unsigned*)((const char*)(gbase) + (voff)[_i]), (PG8_LAS unsigned*)(lds + (bufoff) + ldsw + _i * 8192), 16, 0, 0); } while (0)
#define PG8_LDA(dst, b, h) do { _Pragma("unroll") for (int m = 0; m < 4; ++m) _Pragma("unroll") for (int k = 0; k < 2; ++k) dst[m][k] = *(const PG8_LAS bf16x8*)(lds + PG8_SA(b, h) + aoff + m * 2048 + k * 1024); } while (0)
#define PG8_LDB(dst, b, h) do { _Pragma("unroll") for (int n = 0; n < 2; ++n) _Pragma("unroll") for (int k = 0; k < 2; ++k) dst[n][k] = *(const PG8_LAS bf16x8*)(lds + PG8_SB(b, h) + boff + n * 2048 + k * 1024); } while (0)
#define PG8_MMA(ai, bj, At, Bt) do { __builtin_amdgcn_s_setprio(1); _Pragma("unroll") for (int m = 0; m < 4; ++m) _Pragma("unroll") for (int n = 0; n < 2; ++n) _Pragma("unroll") for (int k = 0; k < 2; ++k) \
        acc[ai][bj][m][n] = __builtin_amdgcn_mfma_f32_16x16x32_bf16(Bt[n][k], At[m][k], acc[ai][bj][m][n], 0, 0, 0); __builtin_amdgcn_s_setprio(0); } while (0)
#define PG8_WAIT_V(n) asm volatile("s_waitcnt vmcnt(" #n ")" ::: "memory")
#define PG8_WAIT_L(n) asm volatile("s_waitcnt lgkmcnt(" #n ")" ::: "memory")
#define PG8_BAR __builtin_amdgcn_s_barrier()
#define PG8_SCHED __builtin_amdgcn_sched_barrier(0)
    Unit cur, nxt; int ui = 0;
    if (!S.next(0, cur)) return;
    f32x4 acc[2][2][4][2];
#pragma unroll
    for (int a = 0; a < 2; ++a)
#pragma unroll
        for (int b = 0; b < 2; ++b)
#pragma unroll
            for (int m = 0; m < 4; ++m)
#pragma unroll
                for (int n = 0; n < 2; ++n) acc[a][b][m][n] = (f32x4){0.f, 0.f, 0.f, 0.f};
    bf16x8 At[4][2], B0[2][2], B1[2][2];
    const char* cA = (const char*)g.A + (size_t)cur.pm * tstep; const char* cB = (const char*)g.Bt + (size_t)cur.pn * tstep;
    S.a_ready(cur);
    if constexpr (SP2) {
        PG8_STAGE(PG8_SB(0, 0), cB, voffB); PG8_STAGE(PG8_SB(0, 1), cB + hstep, voffB); PG8_STAGE(PG8_SA(0, 0), cA, voffA); PG8_STAGE(PG8_SA(0, 1), cA + hstep, voffA);
        if (wr == 1) PG8_BAR;
        PG8_WAIT_V(2); PG8_BAR;
        PG8_STAGE(PG8_SB(1, 0), cB + kstep, voffB); PG8_STAGE(PG8_SA(1, 0), cA + kstep, voffA); PG8_STAGE(PG8_SB(1, 1), cB + hstep + kstep, voffB);
        PG8_WAIT_V(6); PG8_BAR;
    } else {
        PG8_STAGE(PG8_SB(0, 0), cB, voffB); PG8_STAGE(PG8_SA(0, 0), cA, voffA); PG8_STAGE(PG8_SB(0, 1), cB + hstep, voffB); PG8_STAGE(PG8_SA(0, 1), cA + hstep, voffA);
        if (wr == 1) PG8_BAR;
        PG8_WAIT_V(4); PG8_BAR;
        PG8_STAGE(PG8_SB(1, 0), cB + kstep, voffB); PG8_STAGE(PG8_SA(1, 0), cA + kstep, voffA); PG8_STAGE(PG8_SB(1, 1), cB + hstep + kstep, voffB);
        PG8_WAIT_V(6); PG8_BAR;
    }
    for (;;) {
        const bool has_next = S.next(ui + 1, nxt);
        const char* nA = has_next ? (const char*)g.A + (size_t)nxt.pm * tstep : cA; const char* nB = has_next ? (const char*)g.Bt + (size_t)nxt.pn * tstep : cB;
        for (int t = 0; t < nt; t += 2) {
            const bool last = (t == nt - 2);
            const char* a1 = cA + (size_t)(t + 1) * kstep;
            const char* a2 = last ? nA : cA + (size_t)(t + 2) * kstep; const char* b2 = last ? nB : cB + (size_t)(t + 2) * kstep;
            const char* a3 = a2 + kstep; const char* b3 = b2 + kstep;
            if (last && has_next) S.a_ready(nxt);
            if constexpr (SP2) {
            PG8_LDB(B0, 0, 0); PG8_LDB(B1, 0, 1); PG8_SCHED; PG8_LDA(At, 0, 0); PG8_STAGE(PG8_SA(1, 1), a1 + hstep, voffA);
            PG8_WAIT_V(8); PG8_WAIT_L(0); PG8_BAR; PG8_MMA(0, 0, At, B0); PG8_MMA(0, 1, At, B1); PG8_BAR; PG8_SCHED;
            PG8_LDA(At, 0, 1); PG8_STAGE(PG8_SB(0, 0), b2, voffB); PG8_STAGE(PG8_SB(0, 1), b2 + hstep, voffB); PG8_STAGE(PG8_SA(0, 0), a2, voffA);
            PG8_WAIT_V(8); PG8_WAIT_L(0); PG8_BAR; PG8_MMA(1, 0, At, B0); PG8_MMA(1, 1, At, B1); PG8_BAR; PG8_SCHED;
            PG8_LDB(B0, 1, 0); PG8_LDB(B1, 1, 1); PG8_SCHED; PG8_LDA(At, 1, 0); PG8_STAGE(PG8_SA(0, 1), a2 + hstep, voffA);
            PG8_WAIT_V(8); PG8_WAIT_L(0); PG8_BAR; PG8_MMA(0, 0, At, B0); PG8_MMA(0, 1, At, B1); PG8_BAR; PG8_SCHED;
            PG8_LDA(At, 1, 1); PG8_STAGE(PG8_SB(1, 0), b3, voffB); PG8_STAGE(PG8_SB(1, 1), b3 + hstep, voffB); PG8_STAGE(PG8_SA(1, 0), a3, voffA);
            PG8_WAIT_V(8); PG8_WAIT_L(0); PG8_BAR; PG8_MMA(1, 0, At, B0); PG8_MMA(1, 1, At, B1); PG8_BAR; PG8_SCHED;
            } else {
            PG8_LDB(B0, 0, 0); PG8_SCHED; PG8_LDA(At, 0, 0); PG8_STAGE(PG8_SA(1, 1), a1 + hstep, voffA);
            PG8_WAIT_L(8); PG8_BAR; PG8_WAIT_L(0); PG8_MMA(0, 0, At, B0); PG8_BAR; PG8_SCHED;
            PG8_LDB(B1, 0, 1); PG8_STAGE(PG8_SB(0, 0), b2, voffB);
            PG8_BAR; PG8_WAIT_L(0); PG8_MMA(0, 1, At, B1); PG8_BAR;
            PG8_LDA(At, 0, 1); PG8_STAGE(PG8_SA(0, 0), a2, voffA);
            PG8_BAR; PG8_WAIT_L(0); PG8_MMA(1, 0, At, B0); PG8_BAR; PG8_SCHED;
            PG8_STAGE(PG8_SB(0, 1), b2 + hstep, voffB);
            PG8_WAIT_V(6); PG8_BAR; PG8_MMA(1, 1, At, B1); PG8_BAR;
            PG8_LDB(B0, 1, 0); PG8_SCHED; PG8_LDA(At, 1, 0); PG8_STAGE(PG8_SA(0, 1), a2 + hstep, voffA);
            PG8_WAIT_L(8); PG8_BAR; PG8_WAIT_L(0); PG8_MMA(0, 0, At, B0); PG8_BAR; PG8_SCHED;
            PG8_LDB(B1, 1, 1); PG8_STAGE(PG8_SB(1, 0), b3, voffB);
            PG8_BAR; PG8_WAIT_L(0); PG8_MMA(0, 1, At, B1); PG8_BAR;
            PG8_LDA(At, 1, 1); PG8_STAGE(PG8_SA(1, 0), a3, voffA);
            PG8_BAR; PG8_WAIT_L(0); PG8_MMA(1, 0, At, B0); PG8_BAR; PG8_SCHED;
            PG8_STAGE(PG8_SB(1, 1), b3 + hstep, voffB);
            PG8_WAIT_V(6); PG8_BAR; PG8_MMA(1, 1, At, B1); PG8_BAR;
            }
        }
        if constexpr (ALIGN_EPI) { if (wr == 0) PG8_BAR; }
        if constexpr (!Epi::AFTER_DRAIN) { E(acc, cur, wr, wc, fr, fq); S.done(cur); }
        if (!has_next) break;
#pragma unroll
        for (int a = 0; a < 2; ++a)
#pragma unroll
            for (int b = 0; b < 2; ++b)
#pragma unroll
                for (int m = 0; m < 4; ++m)
#pragma unroll
                    for (int n = 0; n < 2; ++n) acc[a][b][m][n] = (f32x4){0.f, 0.f, 0.f, 0.f};
        cur = nxt; cA = nA; cB = nB; ++ui;
        if constexpr (ALIGN_EPI) { if (wr == 1) PG8_BAR; }
    }
    PG8_WAIT_V(0);
    if constexpr (!ALIGN_EPI) { if (wr == 0) PG8_BAR; }
    PG8_BAR;
    if constexpr (Epi::AFTER_DRAIN) { E.fused(acc, cur, wr, wc, fr, fq, lds, wid, lane); S.done(cur); }
#undef PG8_SA
#undef PG8_SB
#undef PG8_STAGE
#undef PG8_LDA
#undef PG8_LDB
#undef PG8_MMA
#undef PG8_WAIT_V
#undef PG8_WAIT_L
#undef PG8_BAR
#undef PG8_SCHED
}
}

#define GAS __attribute__((address_space(1)))
#define LAS __attribute__((address_space(3)))
typedef unsigned short bf16;
typedef unsigned v4u __attribute__((ext_vector_type(4)));
typedef unsigned v2u __attribute__((ext_vector_type(2)));
typedef float f32x4 __attribute__((ext_vector_type(4)));
typedef float f32x2 __attribute__((ext_vector_type(2)));
typedef short bf16x8 __attribute__((ext_vector_type(8)));

constexpr int D = 1024, NB = 8, SEQ = 2048, M = NB * SEQ, DFF = 2816, NUP = 2 * DFF, INC = 4608, S5W = 512, NMOD = 9 * D;
constexpr float EPS = 1e-6f;
constexpr size_t MiB = 1u << 20;
constexpr size_t WS_CTL = 0, CTL_ZERO_BYTES = 64 * 1024;
constexpr size_t WS_MOD = 1 * MiB, WS_LAM16 = 1 * MiB + 512 * 1024;
constexpr size_t WS_W1U = 2 * MiB, WS_W1D = 13 * MiB, WS_W2U = 19 * MiB, WS_W2D = 30 * MiB, WS_WIN = 36 * MiB, WS_WPA = 45 * MiB, WS_WPB = 47 * MiB,
                 WS_WOUT = 48 * MiB, WS_WGLU = 50 * MiB, WS_AY = 51 * MiB, WS_A1 = 57 * MiB;
constexpr size_t WS_U = 60 * MiB, WS_XA = 92 * MiB, WS_GA = 124 * MiB, WS_XB = 156 * MiB, WS_SGA = 172 * MiB, WS_SGB = 204 * MiB, WS_YB = 236 * MiB, WS_END = 252 * MiB;
constexpr size_t WS_H = WS_XA, WS_YB2 = WS_XB, WS_MB = WS_GA;
static_assert(WS_H + (size_t)M * DFF * 2 <= WS_SGB, "h overlay");
constexpr int LDS_BYTES = 147456, RING_BYTES = 131072, MISC_OFF = RING_BYTES + 320;
constexpr int CW_BAR = 1024;

#define LDS_WAIT() asm volatile("s_waitcnt lgkmcnt(0)" ::: "memory")
__device__ __forceinline__ unsigned f2bf(float f) { unsigned u = __builtin_bit_cast(unsigned, f); return (u + 0x7fffu + ((u >> 16) & 1u)) >> 16; }
__device__ __forceinline__ unsigned pk2(float lo, float hi) { return f2bf(lo) | (f2bf(hi) << 16); }
__device__ __forceinline__ float bflo(unsigned w) { return __builtin_bit_cast(float, w << 16); }
__device__ __forceinline__ float bfhi(unsigned w) { return __builtin_bit_cast(float, w & 0xffff0000u); }
__device__ __forceinline__ float bf1(bf16 v) { return __builtin_bit_cast(float, (unsigned)v << 16); }
__device__ __forceinline__ float sigmoidf_fast(float x) { return __builtin_amdgcn_rcpf(1.0f + __expf(-x)); }
__device__ __forceinline__ float gelu_tanh_f(float x) { const float t = 1.5957691216057308f * (x + 0.044715f * x * x * x); return x * sigmoidf_fast(t); }
__device__ __forceinline__ float wave_sum(float v) {
#pragma unroll
    for (int o = 1; o < 64; o <<= 1) v += __shfl_xor(v, o);
    return v;
}
#define XB_TMO      128
#define XB_XCNT(j)  (256  + 64 * (j))
#define XB_XSUB(j)  (1280 + 64 * (j))
#define XB_XGEN(j)  (2304 + 64 * (j))
#define XB_TOP      3328
#define XB_TOPGEN   3392
#define XCD_BAR_WORDS 3456
#define XB_SPIN_CAP (1u << 18)

__device__ __forceinline__ unsigned xb_ld(unsigned* p)              { return __hip_atomic_load(p, __ATOMIC_RELAXED, __HIP_MEMORY_SCOPE_AGENT); }
__device__ __forceinline__ unsigned xb_add(unsigned* p, unsigned v) { return __hip_atomic_fetch_add(p, v, __ATOMIC_RELAXED, __HIP_MEMORY_SCOPE_AGENT); }
__device__ __forceinline__ unsigned xb_xcc_id() { return (unsigned)__builtin_amdgcn_s_getreg((3 << 11) | 20) & 0xFu; }
#define XB_SPIN(cond, bar) do { unsigned _sp = 0; while (cond) { __builtin_amdgcn_s_sleep(1); \
    if ((++_sp & 255u) == 0u) { if (xb_ld(&(bar)[XB_TMO])) break; if (_sp > XB_SPIN_CAP) { atomicAdd(&(bar)[XB_TMO], 1u); break; } } } } while (0)

struct XcdBarrier {
    unsigned* bar; unsigned x;
    volatile LAS unsigned* st;
};

__device__ __forceinline__ XcdBarrier xcd_barrier_post(unsigned* bar, volatile LAS unsigned* st) {
    XcdBarrier b; b.bar = bar; b.x = xb_xcc_id(); b.st = st;
    if (threadIdx.x == 0) (void)xb_add(&bar[XB_XCNT(b.x)], 1u);
    return b;
}
__device__ __forceinline__ void xcd_barrier_complete(unsigned* bar, unsigned x, unsigned& nloc, unsigned& nx) {
    const unsigned G = gridDim.x * gridDim.y * gridDim.z;
    unsigned sum, cnt, mine, sp = 0u;
    for (;;) {
        sum = 0u; cnt = 0u; mine = 0u;
#pragma unroll
        for (unsigned j = 0; j < 16; ++j) { const unsigned c = xb_ld(&bar[XB_XCNT(j)]); sum += c; cnt += (c > 0u) ? 1u : 0u; mine = (j == x) ? c : mine; }
        if (sum == G) break;
        __builtin_amdgcn_s_sleep(1);
        if ((++sp & 255u) == 0u) { if (xb_ld(&bar[XB_TMO])) break; if (sp > XB_SPIN_CAP) { atomicAdd(&bar[XB_TMO], 1u); break; } }
    }
    nloc = mine > 0u ? mine : 1u; nx = cnt > 0u ? cnt : 1u;
}

__device__ __forceinline__ void xcd_barrier(const XcdBarrier& b) {
    asm volatile("s_waitcnt vmcnt(0)" ::: "memory");
    __syncthreads();
    if (threadIdx.x == 0) {
        unsigned* bar = b.bar;
        __builtin_amdgcn_s_waitcnt(0);
        unsigned nloc = b.st[0], nx = b.st[1];
        if (nloc == 0u) { xcd_barrier_complete(bar, b.x, nloc, nx); b.st[0] = nloc; b.st[1] = nx; }
        const unsigned old = xb_add(&bar[XB_XSUB(b.x)], 1u);
        const unsigned gen = old / nloc;
        if (old + 1u == (gen + 1u) * nloc) {
            __builtin_amdgcn_fence(__ATOMIC_RELEASE, "agent");
            asm volatile("s_waitcnt vmcnt(0)" ::: "memory");
            const unsigned og = xb_add(&bar[XB_TOP], 1u);
            const unsigned tg = og / nx;
            if (og + 1u == (tg + 1u) * nx) xb_add(&bar[XB_TOPGEN], 1u);
            else XB_SPIN(xb_ld(&bar[XB_TOPGEN]) == tg, bar);
            __builtin_amdgcn_fence(__ATOMIC_ACQUIRE, "agent");
            xb_add(&bar[XB_XGEN(b.x)], 1u);
            asm volatile("s_waitcnt vmcnt(0)" ::: "memory");
        } else {
            XB_SPIN(xb_ld(&bar[XB_XGEN(b.x)]) == gen, bar);
            __builtin_amdgcn_fence(__ATOMIC_ACQUIRE, "agent");
            asm volatile("s_waitcnt vmcnt(0)" ::: "memory");
        }
    }
    __syncthreads();
}

typedef const f32x4 (&AccRef)[2][2][4][2];
struct EpiSwiglu {
    static constexpr bool PERM = true, AFTER_DRAIN = false;
    bf16* H;
    __device__ __forceinline__ void operator()(AccRef acc, const pg8::Unit& u, int wr, int wc, int fr, int fq) const {
        const int row0 = u.pm * 256 + wr * 64 + fr, col0 = u.pn * 128 + wc * 32 + 8 * fq;
#pragma unroll
        for (int ai = 0; ai < 2; ++ai)
#pragma unroll
            for (int m = 0; m < 4; ++m) {
                bf16* rowp = H + (size_t)(row0 + ai * 128 + m * 16) * DFF + col0;
                float o[8];
#pragma unroll
                for (int n = 0; n < 2; ++n)
#pragma unroll
                    for (int i = 0; i < 4; ++i) { const float a = acc[ai][0][m][n][i], b = acc[ai][1][m][n][i]; o[4 * n + i] = a * sigmoidf_fast(a) * b; }
                v4u w; w.x = pg8::cvt_pk_bf16(o[0], o[1]); w.y = pg8::cvt_pk_bf16(o[2], o[3]); w.z = pg8::cvt_pk_bf16(o[4], o[5]); w.w = pg8::cvt_pk_bf16(o[6], o[7]);
                *(v4u*)rowp = w;
            }
    }
};
struct EpiResid {
    static constexpr bool PERM = false, AFTER_DRAIN = false;
    const float* resid; float* out; const float* gate; float scale;
    __device__ __forceinline__ void operator()(AccRef acc, const pg8::Unit& u, int wr, int wc, int fr, int fq) const {
        const int row0 = u.pm * 256 + wr * 64 + fr, col0 = u.pn * 256 + wc * 32 + 4 * fq, b = u.pm >> 3;
        f32x4 gv[2][2];
#pragma unroll
        for (int bj = 0; bj < 2; ++bj)
#pragma unroll
            for (int n = 0; n < 2; ++n) gv[bj][n] = *(const f32x4*)(gate + (size_t)b * NMOD + col0 + bj * 128 + n * 16) * scale;
#pragma unroll
        for (int ai = 0; ai < 2; ++ai)
#pragma unroll
            for (int m = 0; m < 4; ++m) { const size_t off = (size_t)(row0 + ai * 128 + m * 16) * D + col0;
#pragma unroll
                for (int bj = 0; bj < 2; ++bj)
#pragma unroll
                    for (int n = 0; n < 2; ++n) { const f32x4 r = *(const f32x4*)(resid + off + bj * 128 + n * 16); *(f32x4*)(out + off + bj * 128 + n * 16) = r + gv[bj][n] * acc[ai][bj][m][n]; } }
    }
};
struct EpiWin {
    static constexpr bool PERM = true, AFTER_DRAIN = false;
    bf16 *XA, *GA, *XB, *SGA, *SGB; const float* bias;
    __device__ __forceinline__ void operator()(AccRef acc, const pg8::Unit& u, int wr, int wc, int fr, int fq) const {
        const int pn = u.pn; bf16* base; int ld, ct, act;
        if (pn < 4) { base = XA; ld = 1024; ct = pn; act = 0; } else if (pn < 8) { base = GA; ld = 1024; ct = pn - 4; act = 1; } else if (pn < 10) { base = XB; ld = 512; ct = pn - 8; act = 0; }
        else if (pn < 14) { base = SGA; ld = 1024; ct = pn - 10; act = 2; } else { base = SGB; ld = 1024; ct = pn - 14; act = 2; }
        const int row0 = u.pm * 256 + wr * 64 + fr, cl = wc * 32 + 8 * fq, col0 = ct * 256 + cl, bcol0 = pn * 256 + cl;
        f32x4 bv[2][2];
#pragma unroll
        for (int bj = 0; bj < 2; ++bj)
#pragma unroll
            for (int n = 0; n < 2; ++n) bv[bj][n] = *(const f32x4*)(bias + bcol0 + bj * 128 + 4 * n);
#pragma unroll
        for (int ai = 0; ai < 2; ++ai)
#pragma unroll
            for (int m = 0; m < 4; ++m) { bf16* rowp = base + (size_t)(row0 + ai * 128 + m * 16) * ld + col0;
#pragma unroll
                for (int bj = 0; bj < 2; ++bj) { f32x4 v0 = acc[ai][bj][m][0] + bv[bj][0], v1 = acc[ai][bj][m][1] + bv[bj][1];
                    if (act == 1) {
#pragma unroll
                        for (int i = 0; i < 4; ++i) { v0[i] = gelu_tanh_f(v0[i]); v1[i] = gelu_tanh_f(v1[i]); } }
                    else if (act == 2) {
#pragma unroll
                        for (int i = 0; i < 4; ++i) { v0[i] = sigmoidf_fast(v0[i]); v1[i] = sigmoidf_fast(v1[i]); } }
                    v4u w; w.x = pg8::cvt_pk_bf16(v0[0], v0[1]); w.y = pg8::cvt_pk_bf16(v0[2], v0[3]); w.z = pg8::cvt_pk_bf16(v1[0], v1[1]); w.w = pg8::cvt_pk_bf16(v1[2], v1[3]);
                    *(v4u*)(rowp + bj * 128) = w; } }
    }
};
template <int MODE> struct EpiComb {
    static constexpr bool PERM = true, AFTER_DRAIN = false;
    bf16* out; const bf16* in1; const bf16* in2; const float* bias; int ldc;
    __device__ __forceinline__ void operator()(AccRef acc, const pg8::Unit& u, int wr, int wc, int fr, int fq) const {
        const int row0 = u.pm * 256 + wr * 64 + fr, col0 = u.pn * 256 + wc * 32 + 8 * fq;
        f32x4 bv[2][2];
#pragma unroll
        for (int bj = 0; bj < 2; ++bj)
#pragma unroll
            for (int n = 0; n < 2; ++n) bv[bj][n] = (MODE == 0) ? *(const f32x4*)(bias + col0 + bj * 128 + 4 * n) : (f32x4){0.f, 0.f, 0.f, 0.f};
#pragma unroll
        for (int ai = 0; ai < 2; ++ai)
#pragma unroll
            for (int m = 0; m < 4; ++m) { const size_t off = (size_t)(row0 + ai * 128 + m * 16) * ldc + col0;
#pragma unroll
                for (int bj = 0; bj < 2; ++bj) {
                    const v4u a = *(const v4u*)(in1 + off + bj * 128);
                    float x1[8] = {bflo(a.x), bfhi(a.x), bflo(a.y), bfhi(a.y), bflo(a.z), bfhi(a.z), bflo(a.w), bfhi(a.w)};
                    float x2[8] = {0.f, 0.f, 0.f, 0.f, 0.f, 0.f, 0.f, 0.f};
                    if (MODE == 2) { const v4u c = *(const v4u*)(in2 + off + bj * 128); x2[0] = bflo(c.x); x2[1] = bfhi(c.x); x2[2] = bflo(c.y); x2[3] = bfhi(c.y); x2[4] = bflo(c.z); x2[5] = bfhi(c.z); x2[6] = bflo(c.w); x2[7] = bfhi(c.w); }
                    float o[8];
#pragma unroll
                    for (int n = 0; n < 2; ++n)
#pragma unroll
                        for (int i = 0; i < 4; ++i) { const float v = acc[ai][bj][m][n][i];
                            if (MODE == 0) o[4 * n + i] = x1[4 * n + i] * sigmoidf_fast(v + bv[bj][n][i]);
                            else if (MODE == 1) o[4 * n + i] = x1[4 * n + i] * v;
                            else o[4 * n + i] = x2[4 * n + i] + x1[4 * n + i] * v; }
                    v4u w; w.x = pg8::cvt_pk_bf16(o[0], o[1]); w.y = pg8::cvt_pk_bf16(o[2], o[3]); w.z = pg8::cvt_pk_bf16(o[4], o[5]); w.w = pg8::cvt_pk_bf16(o[6], o[7]);
                    *(v4u*)(out + off + bj * 128) = w; } }
    }
};

struct Params { const float* in[34]; float* out; unsigned char* ws; int use_cg; int pad; };
enum { I_X = 0, I_C, I_MODW, I_MODB, I_N1G, I_F1U, I_F1D, I_N2G, I_WIN, I_BIN, I_CONVW, I_CONVB, I_LWR, I_LBR, I_LWI, I_LBI, I_LAM, I_PA,
       I_SARE, I_SAIM, I_SLDT, I_SBRE, I_SBIM, I_SCRE, I_SCIM, I_SD, I_GLUW, I_GLUB, I_PB, I_WOUT, I_N3G, I_F2U, I_F2D, I_FG };

__device__ __forceinline__ void p0_transpose_item(const float* W, int K, int N, bf16* WT, int drow0, LAS float* scr, int k0, int n0, int lane) {
#pragma unroll 8
    for (int i = 0; i < 32; ++i) { const int kk = 2 * i + (lane >> 5); scr[kk * 33 + (lane & 31)] = W[(size_t)(k0 + kk) * N + n0 + (lane & 31)]; }
    LDS_WAIT(); asm volatile("" ::: "memory");
    const int c = lane & 7;
#pragma unroll
    for (int j = 0; j < 4; ++j) { const int n = (lane >> 3) + 8 * j; const LAS float* s = scr + (8 * c) * 33 + n;
        v4u o; o.x = pk2(s[0 * 33], s[1 * 33]); o.y = pk2(s[2 * 33], s[3 * 33]); o.z = pk2(s[4 * 33], s[5 * 33]); o.w = pk2(s[6 * 33], s[7 * 33]);
        *(v4u*)(WT + (size_t)(drow0 + n) * K + k0 + 8 * c) = o; }
    LDS_WAIT(); asm volatile("" ::: "memory");
}
__device__ __forceinline__ void p0_plain(const float* W, int K, int N, bf16* WT, LAS float* scr, int r, int lane) {
    const int nblk = N / 32, kb = r / nblk, nb = r % nblk; p0_transpose_item(W, K, N, WT, 32 * nb, scr, 64 * kb, 32 * nb, lane);
}
__device__ __forceinline__ void p0_swiglu(const float* W, bf16* WT, LAS float* scr, int r, int lane) {
    const int nblk = NUP / 32, kb = r / nblk, nb = r % nblk, n0 = 32 * nb, half = n0 >= DFF ? 1 : 0, j0 = n0 - half * DFF;
    p0_transpose_item(W, D, NUP, WT, 256 * (j0 >> 7) + 128 * half + (j0 & 127), scr, 64 * kb, n0, lane);
}
__device__ __forceinline__ void p0_mod_unit(const Params& p, float* mod, LAS unsigned char* lds, int unit, int tid, int wave, int lane) {
    LAS float* cs = (LAS float*)lds; LAS float* red = (LAS float*)(lds + 32768);
    const float* c = p.in[I_C]; const float* W = p.in[I_MODW]; const float* bias = p.in[I_MODB];
    for (int i = tid; i < NB * D; i += 512) { const float v = c[i]; cs[i] = v / (1.0f + expf(-v)); }
    __syncthreads();
    const int n0 = unit * 64;
    float acc[8] = {0.f, 0.f, 0.f, 0.f, 0.f, 0.f, 0.f, 0.f};
    const float* wp = W + (size_t)(128 * wave) * NMOD + n0 + lane;
#pragma unroll 8
    for (int k = 0; k < 128; ++k) { const float w = wp[(size_t)k * NMOD];
#pragma unroll
        for (int b = 0; b < 8; ++b) acc[b] += cs[b * D + 128 * wave + k] * w; }
#pragma unroll
    for (int b = 0; b < 8; ++b) red[(wave * 8 + b) * 64 + lane] = acc[b];
    __syncthreads();
    { const int b = wave; float s = bias[n0 + lane];
#pragma unroll
      for (int w = 0; w < 8; ++w) s += red[(w * 8 + b) * 64 + lane];
      mod[(size_t)b * NMOD + n0 + lane] = s; }
    __syncthreads();
}
__device__ __forceinline__ void p0_s5_unit(const Params& p, unsigned char* ws, LAS unsigned char* lds, int g, int tid) {
    LAS f32x2* LP = (LAS f32x2*)lds; LAS f32x2* BBm = (LAS f32x2*)(lds + 8704); LAS f32x2* CCm = (LAS f32x2*)(lds + 16896); LAS float* KF = (LAS float*)(lds + 25088); LAS f32x2* COEF = (LAS f32x2*)(lds + 41472);
    if (tid < 64) {
        const int pp = tid; const double dtd = exp((double)p.in[I_SLDT][g]); const float dt = (float)dtd;
        const float ar = p.in[I_SARE][g * 64 + pp], ai = p.in[I_SAIM][g * 64 + pp];
        for (int j = 0; j <= 16; ++j) {
            const float mag = expf((float)j * ar * dt);
            double rev = (double)j * (double)ai * dtd * 0.15915494309189535; rev -= rint(rev);
            const float th = (float)(rev * 6.283185307179586);
            LP[j * 64 + pp] = (f32x2){mag * cosf(th), mag * sinf(th)};
            if (j == 1) {
                const float sh = sinf(0.5f * th), nr = expm1f(ar * dt) * cosf(th) - 2.0f * sh * sh, li = mag * sinf(th), den = ar * ar + ai * ai;
                COEF[pp] = (f32x2){(nr * ar + li * ai) / den, (li * ar - nr * ai) / den};
            }
        }
    }
    __syncthreads();
    for (int e = tid; e < 1024; e += 512) {
        { const int pp = e >> 4, hh = e & 15; const float br = p.in[I_SBRE][(size_t)(g * 64 + pp) * 16 + hh], bi = p.in[I_SBIM][(size_t)(g * 64 + pp) * 16 + hh]; const f32x2 cf = COEF[pp];
          BBm[pp * 16 + hh] = (f32x2){cf.x * br - cf.y * bi, cf.x * bi + cf.y * br}; }
        { const int hh = e >> 6, pp = e & 63; CCm[hh * 64 + pp] = (f32x2){p.in[I_SCRE][(size_t)(g * 16 + hh) * 64 + pp], p.in[I_SCIM][(size_t)(g * 16 + hh) * 64 + pp]}; }
    }
    __syncthreads();
    {
        const int j = tid >> 5, hh = (tid >> 1) & 15, h0 = (tid & 1) * 8; float acc[8] = {0.f, 0.f, 0.f, 0.f, 0.f, 0.f, 0.f, 0.f};
        for (int pp = 0; pp < 64; ++pp) { const f32x2 c = CCm[hh * 64 + pp], l = LP[j * 64 + pp]; const float qr = c.x * l.x - c.y * l.y, qi = c.x * l.y + c.y * l.x;
#pragma unroll
            for (int i = 0; i < 8; ++i) { const f32x2 bb = BBm[pp * 16 + h0 + i]; acc[i] += qr * bb.x - qi * bb.y; } }
#pragma unroll
        for (int i = 0; i < 8; ++i) KF[(j * 16 + hh) * 16 + h0 + i] = acc[i];
    }
    __syncthreads();
    bf16* AY = (bf16*)(ws + WS_AY) + (size_t)g * 256 * 384; bf16* A1 = (bf16*)(ws + WS_A1) + (size_t)g * 128 * 256;
    for (int v = tid; v < 256 * 48; v += 512) {
        const int row = v / 48, col0 = 8 * (v % 48), tau = row >> 4, hh = row & 15; float o[8];
        if (col0 < 256) { const int s = col0 >> 4, h0 = col0 & 15;
#pragma unroll
            for (int i = 0; i < 8; ++i) o[i] = (s <= tau) ? KF[((tau - s) * 16 + hh) * 16 + h0 + i] : 0.f; }
        else { const int pp0 = col0 - 256, im = pp0 >= 64 ? 1 : 0;
#pragma unroll
            for (int i = 0; i < 8; ++i) { const int pp = (pp0 & 63) + i; const f32x2 c = CCm[hh * 64 + pp], l = LP[(tau + 1) * 64 + pp]; o[i] = im ? -(c.x * l.y + c.y * l.x) : (c.x * l.x - c.y * l.y); } }
        v4u w; w.x = pk2(o[0], o[1]); w.y = pk2(o[2], o[3]); w.z = pk2(o[4], o[5]); w.w = pk2(o[6], o[7]);
        *(v4u*)(AY + (size_t)row * 384 + col0) = w;
    }
    for (int v = tid; v < 128 * 32; v += 512) {
        const int row = v >> 5, col0 = 8 * (v & 31), s = col0 >> 4, h0 = col0 & 15, pp = row & 63, im = row >= 64 ? 1 : 0; const f32x2 l = LP[(15 - s) * 64 + pp]; float o[8];
#pragma unroll
        for (int i = 0; i < 8; ++i) { const f32x2 bb = BBm[pp * 16 + h0 + i]; o[i] = im ? (l.x * bb.y + l.y * bb.x) : (l.x * bb.x - l.y * bb.y); }
        v4u w; w.x = pk2(o[0], o[1]); w.y = pk2(o[2], o[3]); w.z = pk2(o[4], o[5]); w.w = pk2(o[6], o[7]);
        *(v4u*)(A1 + (size_t)row * 256 + col0) = w;
    }
    if (tid < 64) ((f32x2*)(ws + WS_LAM16))[g * 64 + tid] = LP[16 * 64 + tid];
    __syncthreads();
}

__device__ __forceinline__ void norm_mod_rows(const float* xs, const float* gn, const float* mod, int off_sh, int off_sc, bf16* U, int gw, int ngw, int lane) {
    for (int row = gw; row < M; row += ngw) {
        const f32x4* xr = (const f32x4*)(xs + (size_t)row * D) + lane; const int b = row >> 11;
        f32x4 v[4]; float s = 0.f;
#pragma unroll
        for (int j = 0; j < 4; ++j) { v[j] = xr[64 * j]; s += (v[j].x * v[j].x + v[j].y * v[j].y) + (v[j].z * v[j].z + v[j].w * v[j].w); }
        const float rstd = 1.0f / sqrtf(wave_sum(s) * (1.0f / D) + EPS);
        unsigned long long* o8 = (unsigned long long*)(U + (size_t)row * D) + lane;
#pragma unroll
        for (int j = 0; j < 4; ++j) { const int idx = 256 * j + 4 * lane;
            const f32x4 g4 = *(const f32x4*)(gn + idx), sc = *(const f32x4*)(mod + (size_t)b * NMOD + off_sc + idx), sh = *(const f32x4*)(mod + (size_t)b * NMOD + off_sh + idx);
            const f32x4 y = v[j] * rstd * g4 * (sc + 1.0f) + sh;
            o8[64 * j] = (unsigned long long)pk2(y.x, y.y) | ((unsigned long long)pk2(y.z, y.w) << 32); }
    }
}
__device__ __forceinline__ void final_norm_rows(float* xio, const float* gn, int gw, int ngw, int lane) {
    for (int row = gw; row < M; row += ngw) {
        f32x4* xr = (f32x4*)(xio + (size_t)row * D) + lane;
        f32x4 v[4]; float s = 0.f;
#pragma unroll
        for (int j = 0; j < 4; ++j) { v[j] = xr[64 * j]; s += (v[j].x * v[j].x + v[j].y * v[j].y) + (v[j].z * v[j].z + v[j].w * v[j].w); }
        const float rstd = 1.0f / sqrtf(wave_sum(s) * (1.0f / D) + EPS);
#pragma unroll
        for (int j = 0; j < 4; ++j) { const f32x4 g4 = *(const f32x4*)(gn + 256 * j + 4 * lane); xr[64 * j] = v[j] * rstd * g4; }
    }
}

__device__ __forceinline__ void lru_unit(const Params& p, unsigned char* ws, LAS unsigned char* lds, int b, int h, int tid, int wave, int lane) {
    LAS unsigned char* ABF = lds; LAS float* XC = (LAS float*)(lds + 9216); LAS f32x2* AU = (LAS f32x2*)(lds + 26624); LAS f32x2* SEG = (LAS f32x2*)(lds + 59392); LAS float* HCAR = (LAS float*)(lds + 63488);
    const bf16* XA = (const bf16*)(ws + WS_XA); const bf16* GA = (const bf16*)(ws + WS_GA); bf16* YA = (bf16*)(ws + WS_U);
    const int q = lane >> 4, c16 = lane & 15, tb = wave & 3, cbp = wave >> 2;
    bf16x8 Bw[2][2][2];
    float br_[2], bi_[2], sp8[2];
#pragma unroll
    for (int gt = 0; gt < 2; ++gt) { const float* Wg = p.in[gt ? I_LWI : I_LWR] + (size_t)h * 4096;
#pragma unroll
        for (int cbi = 0; cbi < 2; ++cbi) { const int j = 16 * (2 * cbp + cbi) + c16;
#pragma unroll
            for (int ks = 0; ks < 2; ++ks) { bf16x8 f;
#pragma unroll
                for (int e = 0; e < 8; ++e) f[e] = (short)f2bf(Wg[(32 * ks + 8 * q + e) * 64 + j]);
                Bw[gt][cbi][ks] = f; } } }
#pragma unroll
    for (int cbi = 0; cbi < 2; ++cbi) { const int ch = 64 * h + 16 * (2 * cbp + cbi) + c16; br_[cbi] = p.in[I_LBR][ch]; bi_[cbi] = p.in[I_LBI][ch]; sp8[cbi] = 8.0f * log1pf(expf(-p.in[I_LAM][ch])); }
    const int tt = tid >> 3, cg8 = tid & 7;
    float cw[4][8], cb[8];
#pragma unroll
    for (int e = 0; e < 8; ++e) { const int ch = 64 * h + 8 * cg8 + e; cb[e] = p.in[I_CONVB][ch];
#pragma unroll
        for (int k = 0; k < 4; ++k) cw[k][e] = p.in[I_CONVW][k * 1024 + ch]; }
    if (tid < 128) HCAR[tid] = 0.f;
    const size_t rowbase = (size_t)b * SEQ;
    v4u xr[4];
#pragma unroll
    for (int k = 0; k < 4; ++k) { const int t = tt - 3 + k; xr[k] = (t >= 0) ? *(const v4u*)(XA + (rowbase + t) * D + 64 * h + 8 * cg8) : (v4u){0u, 0u, 0u, 0u}; }
    __syncthreads();
    for (int ci = 0; ci < 32; ++ci) {
        const int t0 = 64 * ci;
        {
            float a[8];
#pragma unroll
            for (int e = 0; e < 8; ++e) a[e] = cb[e];
#pragma unroll
            for (int k = 0; k < 4; ++k) { const v4u w = xr[k]; const float xv[8] = {bflo(w.x), bfhi(w.x), bflo(w.y), bfhi(w.y), bflo(w.z), bfhi(w.z), bflo(w.w), bfhi(w.w)};
#pragma unroll
                for (int e = 0; e < 8; ++e) a[e] += cw[k][e] * xv[e]; }
            v4u w; w.x = pk2(a[0], a[1]); w.y = pk2(a[2], a[3]); w.z = pk2(a[4], a[5]); w.w = pk2(a[6], a[7]);
            *(LAS v4u*)(ABF + tt * 144 + cg8 * 16) = w;
            *(LAS f32x4*)(XC + tt * 68 + 8 * cg8) = (f32x4){a[0], a[1], a[2], a[3]};
            *(LAS f32x4*)(XC + tt * 68 + 8 * cg8 + 4) = (f32x4){a[4], a[5], a[6], a[7]};
            if (ci + 1 < 32) {
#pragma unroll
                for (int k = 0; k < 4; ++k) xr[k] = *(const v4u*)(XA + (rowbase + t0 + 64 + tt - 3 + k) * D + 64 * h + 8 * cg8); }
        }
        bf16 gav[8];
#pragma unroll
        for (int k = 0; k < 8; ++k) gav[k] = GA[(rowbase + t0 + 8 * wave + k) * D + 64 * h + lane];
        __syncthreads();
        {
            bf16x8 af[2];
#pragma unroll
            for (int ks = 0; ks < 2; ++ks) af[ks] = *(const LAS bf16x8*)(ABF + (16 * tb + c16) * 144 + 64 * ks + 16 * q);
#pragma unroll
            for (int cbi = 0; cbi < 2; ++cbi) {
                f32x4 ar = {0.f, 0.f, 0.f, 0.f}, ai = {0.f, 0.f, 0.f, 0.f};
                ar = __builtin_amdgcn_mfma_f32_16x16x32_bf16(af[0], Bw[0][cbi][0], ar, 0, 0, 0); ar = __builtin_amdgcn_mfma_f32_16x16x32_bf16(af[1], Bw[0][cbi][1], ar, 0, 0, 0);
                ai = __builtin_amdgcn_mfma_f32_16x16x32_bf16(af[0], Bw[1][cbi][0], ai, 0, 0, 0); ai = __builtin_amdgcn_mfma_f32_16x16x32_bf16(af[1], Bw[1][cbi][1], ai, 0, 0, 0);
                const int chl = 16 * (2 * cbp + cbi) + c16;
#pragma unroll
                for (int r = 0; r < 4; ++r) { const int tok = 16 * tb + 4 * q + r; const float xcv = XC[tok * 68 + chl];
                    const float rg = sigmoidf_fast(ar[r] + br_[cbi]), ig = sigmoidf_fast(ai[r] + bi_[cbi]);
                    const float la = -rg * sp8[cbi], a = __expf(la), x2 = 2.0f * la;
                    const float m2 = (x2 > -0.02f) ? -x2 * (1.0f + x2 * (0.5f + x2 * (0.16666667f + x2 * 0.041666668f))) : 1.0f - __expf(x2);
                    AU[tok * 64 + chl] = (f32x2){a, sqrtf(m2) * ig * xcv}; }
            }
        }
        __syncthreads();
        {
            float hl[8], pk[8]; float P = 1.0f, hh = 0.f;
#pragma unroll
            for (int k = 0; k < 8; ++k) { const f32x2 au = AU[(8 * wave + k) * 64 + lane]; hh = au.x * hh + au.y; P *= au.x; hl[k] = hh; pk[k] = P; }
            SEG[wave * 64 + lane] = (f32x2){P, hh};
            __syncthreads();
            float Hin = HCAR[(ci & 1) * 64 + lane];
            for (int s = 0; s < wave; ++s) { const f32x2 sg = SEG[s * 64 + lane]; Hin = sg.x * Hin + sg.y; }
            float hv = 0.f;
#pragma unroll
            for (int k = 0; k < 8; ++k) { hv = hl[k] + pk[k] * Hin; YA[(rowbase + t0 + 8 * wave + k) * D + 64 * h + lane] = (bf16)f2bf(hv * bf1(gav[k])); }
            if (wave == 7) HCAR[((ci + 1) & 1) * 64 + lane] = hv;
        }
    }
    __syncthreads();
}

__device__ __forceinline__ void s5_unit(const Params& p, unsigned char* ws, LAS unsigned char* lds, int b, int g, int tid, int wave, int lane) {
    LAS unsigned char* XS = lds; LAS float* SS = (LAS float*)(lds + 33792); LAS unsigned char* HP = lds + 67584;
    const bf16* XB = (const bf16*)(ws + WS_XB); bf16* YB = (bf16*)(ws + WS_YB);
    const bf16* AYg = (const bf16*)(ws + WS_AY) + (size_t)g * 256 * 384; const bf16* A1g = (const bf16*)(ws + WS_A1) + (size_t)g * 128 * 256;
    const int q = lane >> 4, c16 = lane & 15, mbA = wave, mbB = 15 - wave;
    bf16x8 a1[8], ayA[12], ayB[12];
#pragma unroll
    for (int ks = 0; ks < 8; ++ks) a1[ks] = *(const bf16x8*)(A1g + (size_t)(16 * wave + c16) * 256 + 32 * ks + 8 * q);
#pragma unroll
    for (int ks = 0; ks < 12; ++ks) { ayA[ks] = *(const bf16x8*)(AYg + (size_t)(16 * mbA + c16) * 384 + 32 * ks + 8 * q); ayB[ks] = *(const bf16x8*)(AYg + (size_t)(16 * mbB + c16) * 384 + 32 * ks + 8 * q); }
    const f32x2 l16 = ((const f32x2*)(ws + WS_LAM16))[g * 64 + lane];
    float Hre = 0.f, Him = 0.f;
    float dsk[4];
#pragma unroll
    for (int r = 0; r < 4; ++r) dsk[r] = p.in[I_SD][16 * g + 4 * q + r];
    for (int half = 0; half < 2; ++half) {
        const size_t tok0 = (size_t)b * SEQ + half * 1024;
#pragma unroll
        for (int i = 0; i < 2; ++i) { const int tl = tid * 2 + i; const v4u* src = (const v4u*)(XB + (tok0 + tl) * S5W + 16 * g); const v4u x0 = src[0], x1 = src[1];
            LAS v4u* dst = (LAS v4u*)(XS + (tl >> 4) * 528 + (tl & 15) * 32); dst[0] = x0; dst[1] = x1; }
        __syncthreads();
#pragma unroll
        for (int nb = 0; nb < 4; ++nb) { f32x4 acc = {0.f, 0.f, 0.f, 0.f};
#pragma unroll
            for (int ks = 0; ks < 8; ++ks) { const bf16x8 bf = *(const LAS bf16x8*)(XS + (16 * nb + c16) * 528 + (2 * ks + (q >> 1)) * 32 + (q & 1) * 16); acc = __builtin_amdgcn_mfma_f32_16x16x32_bf16(a1[ks], bf, acc, 0, 0, 0); }
            *(LAS f32x4*)(SS + (16 * nb + c16) * 132 + 16 * wave + 4 * q) = acc; }
        __syncthreads();
        if (wave == 0) {
            LAS bf16* HPh = (LAS bf16*)HP;
            for (int c = 0; c < 64; ++c) { const float sre = SS[c * 132 + lane], sim = SS[c * 132 + 64 + lane];
                HPh[c * 136 + lane] = (bf16)f2bf(Hre); HPh[c * 136 + 64 + lane] = (bf16)f2bf(Him);
                const float nre = l16.x * Hre - l16.y * Him + sre, nim = l16.x * Him + l16.y * Hre + sim; Hre = nre; Him = nim; }
        }
        __syncthreads();
#pragma unroll
        for (int nb = 0; nb < 4; ++nb) { f32x4 accA = {0.f, 0.f, 0.f, 0.f}, accB = {0.f, 0.f, 0.f, 0.f};
#pragma unroll
            for (int ks = 0; ks < 12; ++ks) {
                const bf16x8 bf = (ks < 8) ? *(const LAS bf16x8*)(XS + (16 * nb + c16) * 528 + (2 * ks + (q >> 1)) * 32 + (q & 1) * 16) : *(const LAS bf16x8*)(HP + (16 * nb + c16) * 272 + (32 * (ks - 8) + 8 * q) * 2);
                if (ks >= 8 || 2 * ks <= mbA) accA = __builtin_amdgcn_mfma_f32_16x16x32_bf16(ayA[ks], bf, accA, 0, 0, 0);
                if (ks >= 8 || 2 * ks <= mbB) accB = __builtin_amdgcn_mfma_f32_16x16x32_bf16(ayB[ks], bf, accB, 0, 0, 0); }
#pragma unroll
            for (int sel = 0; sel < 2; ++sel) { const f32x4 acc = sel ? accB : accA; const int mb = sel ? mbB : mbA; const int j = 16 * nb + c16;
                const v2u xw = *(const LAS v2u*)(XS + j * 528 + mb * 32 + 8 * q); const float xv[4] = {bflo(xw.x), bfhi(xw.x), bflo(xw.y), bfhi(xw.y)};
                float y[4];
#pragma unroll
                for (int r = 0; r < 4; ++r) y[r] = gelu_tanh_f(acc[r] + dsk[r] * xv[r]);
                v2u o; o.x = pk2(y[0], y[1]); o.y = pk2(y[2], y[3]);
                *(v2u*)(YB + (tok0 + 16 * j + mb) * S5W + 16 * g + 4 * q) = o; } }
        __syncthreads();
    }
}

template <class Epi> __device__ __forceinline__ void run_gemm(LAS unsigned char* lds, const bf16* A, const bf16* Bt, int N, int K, const Epi& E) {
    pg8::Gemm g{A, Bt, M, N, K}; pg8::StaticOrder S; S.init(M, N, (int)gridDim.x, (int)blockIdx.x);
    int t = threadIdx.x; asm volatile("" : "+v"(t));
    pg8::gemm_phase<Epi, pg8::StaticOrder, true, true>(lds, g, S, E, t);
}

__global__ void __launch_bounds__(512, 2) fwd_kernel(Params p) {
    extern __shared__ __attribute__((aligned(16))) unsigned char lds_raw[];
    LAS unsigned char* lds = (LAS unsigned char*)lds_raw;
    volatile LAS unsigned* MISC = (volatile LAS unsigned*)(lds + MISC_OFF);
    const int tid = threadIdx.x, lane = tid & 63, wave = __builtin_amdgcn_readfirstlane(tid >> 6);
    const int G = gridDim.x, bid = blockIdx.x, gw = bid * 8 + wave, ngw = G * 8;
    unsigned char* ws = p.ws;
    for (int u = tid; u < (LDS_BYTES - RING_BYTES) / 4; u += 512) ((LAS unsigned*)(lds + RING_BYTES))[u] = 0u;
    __syncthreads();
    XcdBarrier bar = xcd_barrier_post((unsigned*)(ws + WS_CTL) + CW_BAR, MISC + 8);
#define GSYNC() do { if (p.use_cg) cg::this_grid().sync(); else xcd_barrier(bar); } while (0)

    float* mod = (float*)(ws + WS_MOD);
    bf16* W1U = (bf16*)(ws + WS_W1U); bf16* W1D = (bf16*)(ws + WS_W1D); bf16* W2U = (bf16*)(ws + WS_W2U); bf16* W2D = (bf16*)(ws + WS_W2D); bf16* WIN = (bf16*)(ws + WS_WIN);
    bf16* WPA = (bf16*)(ws + WS_WPA); bf16* WPB = (bf16*)(ws + WS_WPB); bf16* WOUT = (bf16*)(ws + WS_WOUT); bf16* WGLU = (bf16*)(ws + WS_WGLU);
    bf16* U = (bf16*)(ws + WS_U); bf16* Hb = (bf16*)(ws + WS_H);
    bf16* XA = (bf16*)(ws + WS_XA); bf16* GA = (bf16*)(ws + WS_GA); bf16* XB = (bf16*)(ws + WS_XB); bf16* SGA = (bf16*)(ws + WS_SGA); bf16* SGB = (bf16*)(ws + WS_SGB);
    bf16* YB = (bf16*)(ws + WS_YB); bf16* YB2 = (bf16*)(ws + WS_YB2); bf16* MB = (bf16*)(ws + WS_MB);
    float* out = p.out;

    for (int u = bid; u < 144 + 32; u += G) { if (u < 144) p0_mod_unit(p, mod, lds, u, tid, wave, lane); else p0_s5_unit(p, ws, lds, u - 144, tid); }
    __syncthreads();
    {
        LAS float* scr = (LAS float*)(lds + wave * 16384);
        constexpr int I_UP = (D / 64) * (NUP / 32), I_DN = (DFF / 64) * (D / 32), I_IN = (D / 64) * (INC / 32), I_SQ = (D / 64) * (D / 32), I_PBn = (S5W / 64) * (D / 32), I_GL = (S5W / 64) * (S5W / 32);
        constexpr int NITEMS = 2 * I_UP + 2 * I_DN + I_IN + 2 * I_SQ + I_PBn + I_GL;
        for (int it = gw; it < NITEMS; it += ngw) {
            int r = it;
            if (r < I_UP) { p0_swiglu(p.in[I_F1U], W1U, scr, r, lane); continue; } r -= I_UP;
            if (r < I_UP) { p0_swiglu(p.in[I_F2U], W2U, scr, r, lane); continue; } r -= I_UP;
            if (r < I_DN) { p0_plain(p.in[I_F1D], DFF, D, W1D, scr, r, lane); continue; } r -= I_DN;
            if (r < I_DN) { p0_plain(p.in[I_F2D], DFF, D, W2D, scr, r, lane); continue; } r -= I_DN;
            if (r < I_IN) { p0_plain(p.in[I_WIN], D, INC, WIN, scr, r, lane); continue; } r -= I_IN;
            if (r < I_SQ) { p0_plain(p.in[I_PA], D, D, WPA, scr, r, lane); continue; } r -= I_SQ;
            if (r < I_SQ) { p0_plain(p.in[I_WOUT], D, D, WOUT, scr, r, lane); continue; } r -= I_SQ;
            if (r < I_PBn) { p0_plain(p.in[I_PB], S5W, D, WPB, scr, r, lane); continue; } r -= I_PBn;
            p0_plain(p.in[I_GLUW], S5W, S5W, WGLU, scr, r, lane);
        }
    }
    GSYNC();
    norm_mod_rows(p.in[I_X], p.in[I_N1G], mod, 0 * D, 1 * D, U, gw, ngw, lane);
    GSYNC();
    { EpiSwiglu E{Hb}; run_gemm(lds, U, W1U, NUP, D, E); }
    GSYNC();
    { EpiResid E{p.in[I_X], out, mod + 2 * D, 0.5f}; run_gemm(lds, Hb, W1D, D, DFF, E); }
    GSYNC();
    norm_mod_rows(out, p.in[I_N2G], mod, 3 * D, 4 * D, U, gw, ngw, lane);
    GSYNC();
    { EpiWin E{XA, GA, XB, SGA, SGB, p.in[I_BIN]}; run_gemm(lds, U, WIN, INC, D, E); }
    GSYNC();
    {
        const int GH = G >> 1;
        if (G >= 2) {
            if (bid < GH) { for (int u = bid; u < NB * 16; u += GH) lru_unit(p, ws, lds, u >> 4, u & 15, tid, wave, lane); }
            else { for (int u = bid - GH; u < NB * 32; u += (G - GH)) s5_unit(p, ws, lds, u >> 5, u & 31, tid, wave, lane); }
        } else { for (int u = 0; u < NB * 16; ++u) lru_unit(p, ws, lds, u >> 4, u & 15, tid, wave, lane); for (int u = 0; u < NB * 32; ++u) s5_unit(p, ws, lds, u >> 5, u & 31, tid, wave, lane); }
    }
    GSYNC();
    { EpiComb<0> E{YB2, YB, nullptr, p.in[I_GLUB], S5W}; run_gemm(lds, YB, WGLU, S5W, S5W, E); }
    GSYNC();
    { EpiComb<1> E{MB, SGA, nullptr, nullptr, D}; run_gemm(lds, U, WPA, D, D, E); }
    { EpiComb<2> E{MB, SGB, MB, nullptr, D}; run_gemm(lds, YB2, WPB, D, S5W, E); }
    GSYNC();
    { EpiResid E{out, out, mod + 5 * D, 1.0f}; run_gemm(lds, MB, WOUT, D, D, E); }
    GSYNC();
    norm_mod_rows(out, p.in[I_N3G], mod, 6 * D, 7 * D, U, gw, ngw, lane);
    GSYNC();
    { EpiSwiglu E{Hb}; run_gemm(lds, U, W2U, NUP, D, E); }
    GSYNC();
    { EpiResid E{out, out, mod + 8 * D, 0.5f}; run_gemm(lds, Hb, W2D, D, DFF, E); }
    GSYNC();
    final_norm_rows(out, p.in[I_FG], gw, ngw, lane);
}

extern "C" void kernel_launch(void* const* d_in, const int* in_sizes, int n_in, void* d_out, int out_size, void* d_ws, size_t ws_size, hipStream_t stream) {
    static int grid = 0;
    if (grid == 0) {
        if (n_in != 34 || in_sizes[0] != M * D || out_size != M * D || ws_size < WS_END) { fprintf(stderr, "kernel_launch: unexpected problem (n_in %d, in0 %d, out %d, ws %zu); nothing launched\n", n_in, n_in > 0 ? in_sizes[0] : -1, out_size, ws_size); grid = -1; return; }
        int dev = 0, cus = 0, per_cu = 0;
        if (hipGetDevice(&dev) != hipSuccess || hipDeviceGetAttribute(&cus, hipDeviceAttributeMultiprocessorCount, dev) != hipSuccess) { grid = -1; return; }
        if (hipFuncSetAttribute((const void*)fwd_kernel, hipFuncAttributeMaxDynamicSharedMemorySize, LDS_BYTES) != hipSuccess) { fprintf(stderr, "kernel_launch: hipFuncSetAttribute failed\n"); grid = -1; return; }
        if (hipOccupancyMaxActiveBlocksPerMultiprocessor(&per_cu, (const void*)fwd_kernel, 512, LDS_BYTES) != hipSuccess || per_cu < 1) { fprintf(stderr, "kernel_launch: occupancy query failed (%d)\n", per_cu); (void)hipGetLastError(); per_cu = 1; }
        grid = cus * per_cu;
    }
    if (grid < 0) return;
    if (hipMemsetAsync((char*)d_ws + WS_CTL, 0, CTL_ZERO_BYTES, stream) != hipSuccess) { fprintf(stderr, "kernel_launch: memset failed\n"); return; }
    Params p{};
    for (int i = 0; i < 34; ++i) p.in[i] = (const float*)d_in[i];
    p.out = (float*)d_out; p.ws = (unsigned char*)d_ws; p.use_cg = USE_CG; p.pad = 0;
    void* args[] = {&p};
    hipError_t e = hipLaunchCooperativeKernel((const void*)fwd_kernel, dim3(grid), dim3(512), args, LDS_BYTES, stream);
    if (e != hipSuccess) fprintf(stderr, "kernel_launch: cooperative launch failed: %s (grid %d)\n", hipGetErrorString(e), grid);
}
```
